# Optimizing an MI355X kernel written in HIP

```python
import math
import jax, jax.numpy as jnp
from jax import lax
import numpy as np

D_MODEL = 1024
BATCH = 8
SEQ = 4096
DEPTH = 4

N_MIXERS = 2
RET_QK_DIM = 256
RET_HEADS = D_MODEL // RET_QK_DIM
RET_V_DIM = 2 * RET_QK_DIM
RET_QK = RET_HEADS * RET_QK_DIM
RET_V = RET_HEADS * RET_V_DIM
RET_CHUNK = 128
ROPE_BASE = 10000.0
DILATED_PAIRS = ((128, 1), (512, 4), (2048, 16))
ATT_GROUPS = 3
ATT_HEAD_DIM = 64
ATT_HEADS = D_MODEL // ATT_HEAD_DIM
ATT_GROUP_W = ATT_HEADS * ATT_HEAD_DIM
BAND_BLOCK = 128
NUM_BUCKETS = 32
MAX_DISTANCE = 2048
D_FF = ((8 * D_MODEL + 3 * 256 - 1) // (3 * 256)) * 256
DEEPNORM_ALPHA = (2 * DEPTH) ** 0.25
DEEPNORM_BETA = (8 * DEPTH) ** -0.25
LN_EPS = 1e-5
GN_EPS = 1e-5

kernel_name = "hybrid_retention_dilated_attn_deepnorm"


def _layer_norm(x, g, b):
    xf = x.astype(jnp.float32)
    mu = jnp.mean(xf, axis=-1, keepdims=True)
    var = jnp.mean(jnp.square(xf - mu), axis=-1, keepdims=True)
    y = (xf - mu) * lax.rsqrt(var + LN_EPS) * g.astype(jnp.float32) + b.astype(jnp.float32)
    return y.astype(x.dtype)


def _rope(x):
    B, T, H, d = x.shape
    inv = 1.0 / (ROPE_BASE ** jnp.linspace(0.0, 1.0, d // 2, dtype=jnp.float32))
    ang = jnp.arange(T, dtype=jnp.float32)[:, None] * inv[None, :]
    c = jnp.cos(ang)[None, :, None, :]
    s = jnp.sin(ang)[None, :, None, :]
    xp = x.reshape(B, T, H, d // 2, 2)
    a, b = xp[..., 0], xp[..., 1]
    return jnp.stack([a * c - b * s, a * s + b * c], axis=-1).reshape(B, T, H, d)


def retention(x, w_in, w_out):
    B, T, _ = x.shape
    H, dk, dv, C = RET_HEADS, RET_QK_DIM, RET_V_DIM, RET_CHUNK
    N = T // C
    proj = x @ w_in
    q, k, v, gate = jnp.split(proj, [RET_QK, 2 * RET_QK, 2 * RET_QK + RET_V], axis=-1)
    q = _rope(q.reshape(B, T, H, dk).astype(jnp.float32))
    k = _rope(k.reshape(B, T, H, dk).astype(jnp.float32)) * (dk ** -0.5)
    v = v.reshape(B, T, H, dv).astype(jnp.float32)

    def to_chunks(t):
        return t.reshape(B, N, C, H, t.shape[-1]).transpose(1, 0, 3, 2, 4)

    qc, kc, vc = to_chunks(q), to_chunks(k), to_chunks(v)
    log_gamma = jnp.log(1.0 - 2.0 ** (-5.0 - jnp.arange(H, dtype=jnp.float32)))
    idx = jnp.arange(C, dtype=jnp.float32)
    diff = idx[:, None] - idx[None, :]
    intra = jnp.where(diff[None] >= 0,
                      jnp.exp(jnp.maximum(diff, 0.0)[None] * log_gamma[:, None, None]), 0.0)
    xi = jnp.exp((idx[None, :] + 1.0) * log_gamma[:, None])[..., None]
    zeta = jnp.exp((C - 1.0 - idx[None, :]) * log_gamma[:, None])[..., None]
    gamma_c = jnp.exp(C * log_gamma)[:, None, None]

    def body(state, inp):
        qi, ki, vi = inp
        s = jnp.einsum('bhid,bhjd->bhij', qi, ki) * intra
        inner = jnp.einsum('bhij,bhje->bhie', s, vi)
        cross = jnp.einsum('bhid,bhde->bhie', qi * xi, state)
        state = gamma_c * state + jnp.einsum('bhjd,bhje->bhde', ki * zeta, vi)
        return state, inner + cross

    state0 = jnp.zeros((B, H, dk, dv), jnp.float32)
    _, y = lax.scan(body, state0, (qc, kc, vc))
    y = y.transpose(1, 0, 3, 2, 4).reshape(B, T, H, dv)
    mu = jnp.mean(y, axis=-1, keepdims=True)
    var = jnp.mean(jnp.square(y - mu), axis=-1, keepdims=True)
    y = ((y - mu) * lax.rsqrt(var + GN_EPS)).reshape(B, T, RET_V).astype(x.dtype)
    return (jax.nn.silu(gate) * y) @ w_out


def _t5_bucket(dist):
    max_exact = NUM_BUCKETS // 2
    d_f = jnp.maximum(dist, 1).astype(jnp.float32)
    large = max_exact + (jnp.log(d_f / max_exact) / math.log(MAX_DISTANCE / max_exact)
                         * (NUM_BUCKETS - max_exact)).astype(jnp.int32)
    large = jnp.minimum(large, NUM_BUCKETS - 1)
    return jnp.where(dist < max_exact, dist, large)


def _dilated_group(q, k, v, bias_table, window, dil):
    B, H, T, hd = q.shape
    blk = BAND_BLOCK
    steps = window // dil
    L = T // dil
    nb = -(-L // blk)
    Lp = nb * blk

    def to_blocks(t):
        t = t.reshape(B, H, L, dil, hd).transpose(0, 1, 3, 2, 4)
        t = jnp.pad(t, ((0, 0), (0, 0), (0, 0), (0, Lp - L), (0, 0)))
        return t.reshape(B, H, dil, nb, blk, hd)

    def band(t):
        prev = jnp.pad(t, ((0, 0), (0, 0), (0, 0), (1, 0), (0, 0), (0, 0)))[:, :, :, :-1]
        return jnp.concatenate([prev, t], axis=4)

    qb = to_blocks(q)
    kw = band(to_blocks(k))
    vw = band(to_blocks(v))
    qi = jnp.arange(blk)[:, None]
    kj = jnp.arange(2 * blk)[None, :]
    delta = qi + blk - kj
    band_ok = (delta >= 0) & (delta <= steps)
    key_ok = (jnp.arange(nb)[:, None, None] * blk - blk + kj[None]) >= 0
    mask = band_ok[None] & key_ok
    bucket = _t5_bucket(jnp.maximum(delta, 0) * dil)
    bias = bias_table[:, bucket].astype(jnp.float32)

    s = jnp.einsum('bhrnqd,bhrnkd->bhrnqk', qb, kw).astype(jnp.float32) * (hd ** -0.5)
    s = s + bias[None, :, None, None]
    s = jnp.where(mask[None, None, None], s, -jnp.inf)
    m = jnp.max(s, axis=-1, keepdims=True)
    e = jnp.exp(s - m)
    den = jnp.sum(e, axis=-1, keepdims=True)
    p = e / den
    lse = (m + jnp.log(den))[..., 0]
    o = jnp.einsum('bhrnqk,bhrnkd->bhrnqd', p.astype(v.dtype), vw)
    o = o.reshape(B, H, dil, Lp, hd)[:, :, :, :L].transpose(0, 1, 3, 2, 4).reshape(B, H, T, hd)
    lse = lse.reshape(B, H, dil, Lp)[..., :L].transpose(0, 1, 3, 2).reshape(B, H, T)
    return o, lse


def dilated_attention(x, w_in, w_out, rel_bias):
    B, T, _ = x.shape
    proj = (x @ w_in).reshape(B, T, 3, ATT_GROUPS, ATT_HEADS, ATT_HEAD_DIM)
    proj = proj.transpose(2, 3, 0, 4, 1, 5)
    outs, lses = [], []
    for g, (window, dil) in enumerate(DILATED_PAIRS):
        o, lse = _dilated_group(proj[0, g], proj[1, g], proj[2, g],
                                rel_bias[g * ATT_HEADS:(g + 1) * ATT_HEADS], window, dil)
        outs.append(o)
        lses.append(lse)
    w = jax.nn.softmax(jnp.stack(lses, axis=0), axis=0)
    o = jnp.sum(w[..., None] * jnp.stack(outs, axis=0).astype(jnp.float32), axis=0)
    o = o.transpose(0, 2, 1, 3).reshape(B, T, ATT_GROUP_W).astype(x.dtype)
    return o @ w_out


def swiglu_ffn(x, w_up, w_down):
    gate, up = jnp.split(x @ w_up, 2, axis=-1)
    return (jax.nn.silu(gate) * up) @ w_down


def setup_inputs(seed: int = 0) -> dict:
    key = jax.random.key(seed)
    ks = jax.random.split(key, 10)
    n_ret = (DEPTH + 1) // 2
    n_att = DEPTH // 2
    f32 = jnp.float32
    x = jax.random.normal(ks[0], (BATCH, SEQ, D_MODEL), f32)
    ret_w_in = jax.random.normal(ks[1], (n_ret, D_MODEL, 2 * RET_QK + 2 * RET_V), f32) * D_MODEL ** -0.5
    ret_w_out = jax.random.normal(ks[2], (n_ret, RET_V, D_MODEL), f32) * (RET_V ** -0.5 * DEEPNORM_BETA)
    attn_w_in = jax.random.normal(ks[3], (n_att, D_MODEL, 3 * ATT_GROUPS * ATT_GROUP_W), f32) * D_MODEL ** -0.5
    attn_w_out = jax.random.normal(ks[4], (n_att, ATT_GROUP_W, D_MODEL), f32) * (ATT_GROUP_W ** -0.5 * DEEPNORM_BETA)
    rel_bias = jax.random.normal(ks[5], (ATT_GROUPS * ATT_HEADS, NUM_BUCKETS), f32) * 0.2
    ffn_w_up = jax.random.normal(ks[6], (DEPTH, D_MODEL, 2 * D_FF), f32) * D_MODEL ** -0.5
    ffn_w_down = jax.random.normal(ks[7], (DEPTH, D_FF, D_MODEL), f32) * (D_FF ** -0.5 * DEEPNORM_BETA)
    ln_gain = 1.0 + 0.02 * jax.random.normal(ks[8], (DEPTH, 2, D_MODEL), f32)
    ln_bias = 0.02 * jax.random.normal(ks[9], (DEPTH, 2, D_MODEL), f32)
    return {"x": x, "ret_w_in": ret_w_in, "ret_w_out": ret_w_out,
            "attn_w_in": attn_w_in, "attn_w_out": attn_w_out, "rel_bias": rel_bias,
            "ffn_w_up": ffn_w_up, "ffn_w_down": ffn_w_down,
            "ln_gain": ln_gain, "ln_bias": ln_bias}


def reference(x, ret_w_in, ret_w_out, attn_w_in, attn_w_out, rel_bias,
              ffn_w_up, ffn_w_down, ln_gain, ln_bias):
    for i in range(DEPTH):
        j = i // N_MIXERS
        if i % N_MIXERS == 0:
            mix = retention(x, ret_w_in[j], ret_w_out[j])
        else:
            mix = dilated_attention(x, attn_w_in[j], attn_w_out[j], rel_bias)
        x = _layer_norm(DEEPNORM_ALPHA * x + mix, ln_gain[i, 0], ln_bias[i, 0])
        x = _layer_norm(DEEPNORM_ALPHA * x + swiglu_ffn(x, ffn_w_up[i], ffn_w_down[i]),
                        ln_gain[i, 1], ln_bias[i, 1])
    return x
```

```cpp
#include <hip/hip_runtime.h>
#include <cstdio>
#include <cstdint>
#include <cmath>
namespace pg8 {
#define PG8_LAS __attribute__((address_space(3)))
typedef unsigned short bf16_t;
typedef short bf16x8 __attribute__((ext_vector_type(8)));
typedef float f32x4 __attribute__((ext_vector_type(4)));
typedef unsigned u32x4 __attribute__((ext_vector_type(4)));
constexpr int BM = 256, BK = 64, HALF = 128, HTB = HALF * BK * 2  , STAGE_BYTES = 8 * HTB, NXCD = 8, WGM = 8;

__host__ __device__ __forceinline__ int lds_byte(int r, int c) { const int st = (r >> 4) * 2 + (c >> 5), rr = r & 15, cc = c & 31, ob = rr * 64 + cc * 2; return st * 1024 + (ob ^ (((ob >> 9) & 1) << 5)); }
__host__ __device__ __forceinline__ void stage_rc(int b, int& R, int& C) { const int st = b / 1024, sb = b % 1024, swz = sb ^ (((sb >> 9) & 1) << 5); R = (st >> 1) * 16 + swz / 64; C = (st & 1) * 32 + (swz % 64) / 2; }
__host__ __device__ __forceinline__ int perm32(int rho) { const int n = rho >> 4, i = rho & 15; return 8 * (i >> 2) + 4 * n + (i & 3); }

struct Unit { int pm, pn; };
struct Gemm { const bf16_t* A; const bf16_t* Bt; int M, N, K; };

struct StaticOrder {
    int nM, nN, nwg, G, c;
    __host__ __device__ void init(int M, int N, int G_, int c_) { nM = M / BM; nN = N / BM; nwg = nM * nN; G = G_; c = c_; }
    __host__ __device__ bool next(int i, Unit& u) const {
        const long L = (long)i * G + c; if (L >= nwg) return false;
        int wgid = (int)L; { const int q = nwg / NXCD, r = nwg % NXCD, xcd = wgid % NXCD, off = wgid / NXCD; wgid = (xcd < r ? xcd * (q + 1) : r * (q + 1) + (xcd - r) * q) + off; }
        const int nig = WGM * nN, gid = wgid / nig, fm = gid * WGM, gsz = (nM - fm) < WGM ? (nM - fm) : WGM;
        u.pm = fm + ((wgid % nig) % gsz); u.pn = (wgid % nig) / gsz; return true;
    }
    __device__ __forceinline__ void a_ready(const Unit&) const {}
    __device__ __forceinline__ void done(const Unit&) const {}
};

__device__ __forceinline__ unsigned cvt_pk_bf16(float lo, float hi) { unsigned r; asm volatile("v_cvt_pk_bf16_f32 %0, %1, %2" : "=v"(r) : "v"(lo), "v"(hi)); return r; }
typedef float f32x2 __attribute__((ext_vector_type(2)));
__device__ __forceinline__ f32x2 gelu_pk(f32x2 v) {
    const f32x2 av = __builtin_elementwise_abs(v), d = av * 0.2316418882f + 1.0f;
    f32x2 t; t.x = __builtin_amdgcn_rcpf(d.x); t.y = __builtin_amdgcn_rcpf(d.y);
    f32x2 q = t * 0.5307027145f + (-0.7265760135f); q = q * t + 0.7107068705f; q = q * t + (-0.142248368f); q = q * t + 0.127414796f; q = q * t;
    const f32x2 s = (v * v) * (-0.72134752044f);
    f32x2 e; e.x = __builtin_amdgcn_exp2f(s.x); e.y = __builtin_amdgcn_exp2f(s.y);
    const f32x2 m = v * (q * e), r = v - m;
    f32x2 o; o.x = v.x < 0.f ? m.x : r.x; o.y = v.y < 0.f ? m.y : r.y; return o;
}

template <int ACT  > struct EpiBf16 {
    static constexpr bool PERM = true, AFTER_DRAIN = false; static_assert(ACT == 0 || ACT == 1, "EpiBf16: ACT is 0 (none) or 1 (gelu_pk)");
    bf16_t* O; int ldc; const float* bias; int split_cols; size_t split_stride; float scale0;
    __device__ __forceinline__ void operator()(const f32x4 (&acc)[2][2][4][2], const Unit& u, int wr, int wc, int fr, int fq) const {
        const int row0 = u.pm * BM + wr * 64 + fr; int colt = u.pn * BM; bf16_t* base = O;
        float sc = 1.f; if (split_cols) { const int t = colt / split_cols; base += (size_t)t * split_stride; colt -= t * split_cols; if (t == 0) sc = scale0; }
        const int col0 = colt + wc * 32 + 8 * fq, bcol0 = u.pn * BM + wc * 32 + 8 * fq;
        f32x4 bv[2][2];
#pragma unroll
        for (int bj = 0; bj < 2; ++bj)
#pragma unroll
            for (int n = 0; n < 2; ++n) bv[bj][n] = bias ? *(const f32x4*)(bias + bcol0 + bj * HALF + 4 * n) : (f32x4){0.f, 0.f, 0.f, 0.f};
#pragma unroll
        for (int ai = 0; ai < 2; ++ai)
#pragma unroll
            for (int m = 0; m < 4; ++m) { bf16_t* rowp = base + (size_t)(row0 + ai * HALF + m * 16) * ldc + col0;
#pragma unroll
                for (int bj = 0; bj < 2; ++bj) { f32x4 v0 = acc[ai][bj][m][0] + bv[bj][0], v1 = acc[ai][bj][m][1] + bv[bj][1];
                    if (ACT == 1) { f32x2 a = gelu_pk((f32x2){v0[0], v0[1]}), b = gelu_pk((f32x2){v0[2], v0[3]}), c = gelu_pk((f32x2){v1[0], v1[1]}), d = gelu_pk((f32x2){v1[2], v1[3]});
                        v0 = (f32x4){a.x, a.y, b.x, b.y}; v1 = (f32x4){c.x, c.y, d.x, d.y}; }
                    v0 = v0 * sc; v1 = v1 * sc; u32x4 w; w.x = cvt_pk_bf16(v0[0], v0[1]); w.y = cvt_pk_bf16(v0[2], v0[3]); w.z = cvt_pk_bf16(v1[0], v1[1]); w.w = cvt_pk_bf16(v1[2], v1[3]);
                    *(u32x4*)(rowp + bj * HALF) = w; } }
    }
};

struct PanelStats {
    unsigned* xbuf;
    unsigned* cnt;
    unsigned* tmo;
    int ntn; float eps;
    unsigned code;
    __device__ __forceinline__ bool run(const f32x4 (&v)[2][2][4][2], const Unit& u, int wr, int wc, int fr, int fq, PG8_LAS unsigned char* lds, int wid, int lane) const {
        typedef float f32x2v __attribute__((ext_vector_type(2)));
        PG8_LAS f32x2v* P = (PG8_LAS f32x2v*)lds;
        PG8_LAS f32x2v* S = (PG8_LAS f32x2v*)(lds + 8192);
        PG8_LAS unsigned* flag = (PG8_LAS unsigned*)(lds + 8192 + 2048);
#pragma unroll
        for (int ai = 0; ai < 2; ++ai)
#pragma unroll
            for (int m = 0; m < 4; ++m) {
                float s = 0.f;
#pragma unroll
                for (int bj = 0; bj < 2; ++bj)
#pragma unroll
                    for (int n = 0; n < 2; ++n) { const f32x4 x = v[ai][bj][m][n]; s += (x[0] + x[1]) + (x[2] + x[3]); }
                s += __shfl_xor(s, 16); s += __shfl_xor(s, 32);
                const float mw = s * (1.0f / 64.0f); float q = 0.f;
#pragma unroll
                for (int bj = 0; bj < 2; ++bj)
#pragma unroll
                    for (int n = 0; n < 2; ++n) { const f32x4 d = v[ai][bj][m][n] - mw; q += (d[0] * d[0] + d[1] * d[1]) + (d[2] * d[2] + d[3] * d[3]); }
                q += __shfl_xor(q, 16); q += __shfl_xor(q, 32);
                if (fq == 0) P[(ai * HALF + wr * 64 + m * 16 + fr) * 4 + wc] = (f32x2v){mw, q};
            }
        asm volatile("s_waitcnt lgkmcnt(0)" ::: "memory"); __builtin_amdgcn_s_barrier(); asm volatile("" ::: "memory");
#if defined(BROKEN_EXCHANGE_NO_WAIT)
#warning BROKEN CONTROL BUILD: the row-statistics exchange does not wait; results are wrong by design
        if (blockIdx.x >= 64) { const long long t0_ = clock64(); while (clock64() - t0_ < 60000) __builtin_amdgcn_s_sleep(8); }
#endif
        const int row = wid * 32 + (lane & 31);
        if (lane < 32) {
            const f32x2v a = P[row * 4 + 0], b = P[row * 4 + 1], c = P[row * 4 + 2], d = P[row * 4 + 3];
            const float mt = (a.x + b.x + c.x + d.x) * 0.25f;
            const float da = a.x - mt, db = b.x - mt, dc = c.x - mt, dd = d.x - mt;
            const float m2 = (a.y + b.y) + (c.y + d.y) + 64.0f * ((da * da + db * db) + (dc * dc + dd * dd));
            unsigned long long* slot = (unsigned long long*)xbuf + ((size_t)(u.pm * BM + row) * 4 + u.pn);
            __hip_atomic_store(slot, ((unsigned long long)__float_as_uint(m2) << 32) | __float_as_uint(mt), __ATOMIC_RELAXED, __HIP_MEMORY_SCOPE_AGENT);
        }
        asm volatile("s_waitcnt vmcnt(0)" ::: "memory");
        if (lane == 0) __hip_atomic_fetch_add(cnt + 64 * u.pm, 1u, __ATOMIC_RELAXED, __HIP_MEMORY_SCOPE_AGENT);
        if (wid == 0) {
            bool dead = false; const unsigned long long t0 = __builtin_amdgcn_s_memrealtime(); const unsigned want = 8u * (unsigned)ntn;
            for (;;) {
#if defined(BROKEN_EXCHANGE_NO_WAIT)
                break;
#endif
                if ((unsigned)__builtin_amdgcn_readfirstlane(__hip_atomic_load(cnt + 64 * u.pm, __ATOMIC_RELAXED, __HIP_MEMORY_SCOPE_AGENT)) >= want) break;
                if (__builtin_amdgcn_s_memrealtime() - t0 > 2000000ull) {
                    if (lane == 0) { unsigned expect = 0u; __hip_atomic_compare_exchange_strong(tmo + 1, &expect, code | (unsigned)(u.pm & 0xff), __ATOMIC_RELAXED, __ATOMIC_RELAXED, __HIP_MEMORY_SCOPE_AGENT);
                                     __hip_atomic_store(tmo, 1u, __ATOMIC_RELAXED, __HIP_MEMORY_SCOPE_AGENT); }
                    dead = true; break; }
                __builtin_amdgcn_s_sleep(2);
            }
            __builtin_amdgcn_fence(__ATOMIC_ACQUIRE, "agent");
            if (lane == 0) flag[0] = dead ? 1u : 0u;
        }
        asm volatile("s_waitcnt vmcnt(0) lgkmcnt(0)" ::: "memory"); __builtin_amdgcn_s_barrier(); asm volatile("" ::: "memory");
        const bool bad = flag[0] != 0u;
        if (lane < 32) {
            const unsigned long long* slot = (const unsigned long long*)xbuf + (size_t)(u.pm * BM + row) * 4; float mt[4], m2[4]; float ms = 0.f;
#pragma unroll
            for (int t = 0; t < 4; ++t) { if (t < ntn) { const unsigned long long w = __hip_atomic_load(slot + t, __ATOMIC_RELAXED, __HIP_MEMORY_SCOPE_AGENT); mt[t] = __uint_as_float((unsigned)w); m2[t] = __uint_as_float((unsigned)(w >> 32)); } else { mt[t] = 0.f; m2[t] = 0.f; } ms += mt[t]; }
            const float mean = ms / (float)ntn; float q = 0.f;
#pragma unroll
            for (int t = 0; t < 4; ++t) if (t < ntn) { const float dm = mt[t] - mean; q += m2[t] + 256.0f * dm * dm; }
            S[row] = (f32x2v){mean, 1.0f / sqrtf(q / (256.0f * (float)ntn) + eps)};
        }
        asm volatile("s_waitcnt lgkmcnt(0)" ::: "memory"); __builtin_amdgcn_s_barrier(); asm volatile("" ::: "memory");
        return bad;
    }
};
struct EpiLnRes {
    static constexpr bool PERM = false, AFTER_DRAIN = true;
    const float* base; float* out; int ldc; const float* bias; PanelStats st; unsigned poison;
    __device__ __forceinline__ void fused(f32x4 (&acc)[2][2][4][2], const Unit& u, int wr, int wc, int fr, int fq, PG8_LAS unsigned char* lds, int wid, int lane) const {
        typedef float f32x2v __attribute__((ext_vector_type(2)));
        const PG8_LAS f32x2v* S = (const PG8_LAS f32x2v*)(lds + 8192);
        const int col0 = u.pn * BM + wc * 32 + 4 * fq;
#pragma unroll
        for (int bj = 0; bj < 2; ++bj)
#pragma unroll
            for (int n = 0; n < 2; ++n) { const f32x4 bv = bias ? *(const f32x4*)(bias + col0 + bj * HALF + n * 16) : (f32x4){0.f, 0.f, 0.f, 0.f};
#pragma unroll
                for (int ai = 0; ai < 2; ++ai)
#pragma unroll
                    for (int m = 0; m < 4; ++m) acc[ai][bj][m][n] += bv; }
        f32x4 pre[4][2][2];
#pragma unroll
        for (int m = 0; m < 4; ++m) { const size_t off = (size_t)(u.pm * BM + wr * 64 + m * 16 + fr) * ldc + col0;
#pragma unroll
            for (int bj = 0; bj < 2; ++bj)
#pragma unroll
                for (int n = 0; n < 2; ++n) pre[m][bj][n] = *(const f32x4*)(base + off + bj * HALF + n * 16); }
        const bool bad = st.run(acc, u, wr, wc, fr, fq, lds, wid, lane) || poison != 0u;
        const float qnan = __builtin_nanf("");
#pragma unroll
        for (int ai = 0; ai < 2; ++ai)
#pragma unroll
            for (int m = 0; m < 4; ++m) { const int r = ai * HALF + wr * 64 + m * 16 + fr; const f32x2v sr = S[r]; const size_t off = (size_t)(u.pm * BM + r) * ldc + col0;
#pragma unroll
                for (int bj = 0; bj < 2; ++bj)
#pragma unroll
                    for (int n = 0; n < 2; ++n) { const f32x4 bs = ai == 0 ? pre[m][bj][n] : *(const f32x4*)(base + off + bj * HALF + n * 16); f32x4 o = bs + (acc[ai][bj][m][n] - sr.x) * sr.y;
                        if (bad) o = (f32x4){qnan, qnan, qnan, qnan}; *(f32x4*)(out + off + bj * HALF + n * 16) = o; }
                if (m & 1) asm volatile("" ::: "memory"); }
    }
};
struct EpiLnResLn {
    static constexpr bool PERM = false, AFTER_DRAIN = true;
    const float* base; float* out; bf16_t* xn; int ldc; const float* bias; PanelStats st1, st2; unsigned poison;
    __device__ __forceinline__ void fused(f32x4 (&acc)[2][2][4][2], const Unit& u, int wr, int wc, int fr, int fq, PG8_LAS unsigned char* lds, int wid, int lane) const {
        typedef float f32x2v __attribute__((ext_vector_type(2))); typedef unsigned u32x2v __attribute__((ext_vector_type(2)));
        const PG8_LAS f32x2v* S = (const PG8_LAS f32x2v*)(lds + 8192);
        const int col0 = u.pn * BM + wc * 32 + 4 * fq;
#pragma unroll
        for (int bj = 0; bj < 2; ++bj)
#pragma unroll
            for (int n = 0; n < 2; ++n) { const f32x4 bv = bias ? *(const f32x4*)(bias + col0 + bj * HALF + n * 16) : (f32x4){0.f, 0.f, 0.f, 0.f};
#pragma unroll
                for (int ai = 0; ai < 2; ++ai)
#pragma unroll
                    for (int m = 0; m < 4; ++m) acc[ai][bj][m][n] += bv; }
        bool bad = st1.run(acc, u, wr, wc, fr, fq, lds, wid, lane) || poison != 0u;
        const float qnan = __builtin_nanf("");
#pragma unroll
        for (int ai = 0; ai < 2; ++ai)
#pragma unroll
            for (int m = 0; m < 4; ++m) { const int r = ai * HALF + wr * 64 + m * 16 + fr; const f32x2v sr = S[r]; const size_t off = (size_t)(u.pm * BM + r) * ldc + col0;
#pragma unroll
                for (int bj = 0; bj < 2; ++bj)
#pragma unroll
                    for (int n = 0; n < 2; ++n) { const f32x4 bs = *(const f32x4*)(base + off + bj * HALF + n * 16); acc[ai][bj][m][n] = bs + (acc[ai][bj][m][n] - sr.x) * sr.y; }
                asm volatile("" : "+v"(acc[ai][0][m][0]), "+v"(acc[ai][0][m][1]), "+v"(acc[ai][1][m][0]), "+v"(acc[ai][1][m][1]));
                if (m & 1) asm volatile("" ::: "memory"); }
        const bool bad1 = bad;
        bad = st2.run(acc, u, wr, wc, fr, fq, lds, wid, lane) || bad;
#pragma unroll
        for (int ai = 0; ai < 2; ++ai)
#pragma unroll
            for (int m = 0; m < 4; ++m) { const int r = ai * HALF + wr * 64 + m * 16 + fr; const f32x2v sr = S[r]; const size_t off = (size_t)(u.pm * BM + r) * ldc + col0;
#pragma unroll
                for (int bj = 0; bj < 2; ++bj)
#pragma unroll
                    for (int n = 0; n < 2; ++n) { const f32x4 x1 = acc[ai][bj][m][n]; *(f32x4*)(out + off + bj * HALF + n * 16) = bad1 ? (f32x4){qnan, qnan, qnan, qnan} : x1;
                        const f32x4 o = (x1 - sr.x) * sr.y; u32x2v w; w.x = cvt_pk_bf16(o[0], o[1]); w.y = cvt_pk_bf16(o[2], o[3]);
                        if (bad) { w.x = 0x7fc07fc0u; w.y = 0x7fc07fc0u; } *(u32x2v*)(xn + off + bj * HALF + n * 16) = w; }
                asm volatile("" ::: "memory"); }
    }
};

template <class Epi, class Sched, bool ALIGN_EPI = false, bool SP2 = false>
__device__ __forceinline__ void gemm_phase(PG8_LAS unsigned char* lds, const Gemm g, const Sched& S, const Epi& E, const int tid) {
    const int wid = __builtin_amdgcn_readfirstlane(tid >> 6), lane = tid & 63, wr = wid >> 2, wc = wid & 3, fr = lane & 15, fq = lane >> 4;
    const int K = g.K, nt = K / BK;
    unsigned voffA[2], voffB[2];
#pragma unroll
    for (int i = 0; i < 2; ++i) { int R, C; stage_rc(tid * 16 + i * 8192, R, C); const int Rb = Epi::PERM ? ((R & ~31) + perm32(R & 31)) : R;
        voffA[i] = (unsigned)(R * K + C) * 2u; voffB[i] = (unsigned)(Rb * K + C) * 2u; }
    const size_t kstep = (size_t)(BK * 2);
    const size_t hstep = (size_t)HALF * K * 2;
    const size_t tstep = 2 * hstep;
    const unsigned ldsw = (unsigned)wid * 1024u;
    const int aoff = lds_byte(wr * 64 + fr, fq * 8), boff = lds_byte(wc * 32 + fr, fq * 8);
#define PG8_SA(b, h) (((b) * 2 + (h)) * HTB)
#define PG8_SB(b, h) ((4 + (b) * 2 + (h)) * HTB)
#define PG8_STAGE(bufoff, gbase, voff) do { _Pragma("unroll") for (int _i = 0; _i < 2; ++_i) \
        __builtin_amdgcn_global_load_lds((const unsigned*)((const char*)(gbase) + (voff)[_i]), (PG8_LAS unsigned*)(lds + (bufoff) + ldsw + _i * 8192), 16, 0, 0); } while (0)
#define PG8_LDA(dst, b, h) do { _Pragma("unroll") for (int m = 0; m < 4; ++m) _Pragma("unroll") for (int k = 0; k < 2; ++k) dst[m][k] = *(const PG8_LAS bf16x8*)(lds + PG8_SA(b, h) + aoff + m * 2048 + k * 1024); } while (0)
#define PG8_LDB(dst, b, h) do { _Pragma("unroll") for (int n = 0; n < 2; ++n) _Pragma("unroll") for (int k = 0; k < 2; ++k) dst[n][k] = *(const PG8_LAS bf16x8*)(lds + PG8_SB(b, h) + boff + n * 2048 + k * 1024); } while (0)
#define PG8_MMA(ai, bj, At, Bt) do { __builtin_amdgcn_s_setprio(1); _Pragma("unroll") for (int m = 0; m < 4; ++m) _Pragma("unroll") for (int n = 0; n < 2; ++n) _Pragma("unroll") for (int k = 0; k < 2; ++k) \
        acc[ai][bj][m][n] = __builtin_amdgcn_mfma_f32_16x16x32_bf16(Bt[n][k], At[m][k], acc[ai][bj][m][n], 0, 0, 0); __builtin_amdgcn_s_setprio(0); } while (0)
#define PG8_WAIT_V(n) asm volatile("s_waitcnt vmcnt(" #n ")" ::: "memory")
#define PG8_WAIT_L(n) asm volatile("s_waitcnt lgkmcnt(" #n ")" ::: "memory")
#define PG8_BAR __builtin_amdgcn_s_barrier()
#define PG8_SCHED __builtin_amdgcn_sched_barrier(0)
    Unit cur, nxt; int ui = 0;
    if (!S.next(0, cur)) return;
    f32x4 acc[2][2][4][2];
#pragma unroll
    for (int a = 0; a < 2; ++a)
#pragma unroll
        for (int b = 0; b < 2; ++b)
#pragma unroll
            for (int m = 0; m < 4; ++m)
#pragma unroll
                for (int n = 0; n < 2; ++n) acc[a][b][m][n] = (f32x4){0.f, 0.f, 0.f, 0.f};
    bf16x8 At[4][2], B0[2][2], B1[2][2];
    const char* cA = (const char*)g.A + (size_t)cur.pm * tstep; const char* cB = (const char*)g.Bt + (size_t)cur.pn * tstep;
    S.a_ready(cur);
    if constexpr (SP2) {
        PG8_STAGE(PG8_SB(0, 0), cB, voffB); PG8_STAGE(PG8_SB(0, 1), cB + hstep, voffB); PG8_STAGE(PG8_SA(0, 0), cA, voffA); PG8_STAGE(PG8_SA(0, 1), cA + hstep, voffA);
        if (wr == 1) PG8_BAR;
        PG8_WAIT_V(2); PG8_BAR;
        PG8_STAGE(PG8_SB(1, 0), cB + kstep, voffB); PG8_STAGE(PG8_SA(1, 0), cA + kstep, voffA); PG8_STAGE(PG8_SB(1, 1), cB + hstep + kstep, voffB);
        PG8_WAIT_V(6); PG8_BAR;
    } else {
        PG8_STAGE(PG8_SB(0, 0), cB, voffB); PG8_STAGE(PG8_SA(0, 0), cA, voffA); PG8_STAGE(PG8_SB(0, 1), cB + hstep, voffB); PG8_STAGE(PG8_SA(0, 1), cA + hstep, voffA);
        if (wr == 1) PG8_BAR;
        PG8_WAIT_V(4); PG8_BAR;
        PG8_STAGE(PG8_SB(1, 0), cB + kstep, voffB); PG8_STAGE(PG8_SA(1, 0), cA + kstep, voffA); PG8_STAGE(PG8_SB(1, 1), cB + hstep + kstep, voffB);
        PG8_WAIT_V(6); PG8_BAR;
    }
    for (;;) {
        const bool has_next = S.next(ui + 1, nxt);
        const char* nA = has_next ? (const char*)g.A + (size_t)nxt.pm * tstep : cA; const char* nB = has_next ? (const char*)g.Bt + (size_t)nxt.pn * tstep : cB;
        for (int t = 0; t < nt; t += 2) {
            const bool last = (t == nt - 2);
            const char* a1 = cA + (size_t)(t + 1) * kstep;
            const char* a2 = last ? nA : cA + (size_t)(t + 2) * kstep; const char* b2 = last ? nB : cB + (size_t)(t + 2) * kstep;
            const char* a3 = a2 + kstep; const char* b3 = b2 + kstep;
            if (last && has_next) S.a_ready(nxt);
            if constexpr (SP2) {
            PG8_LDB(B0, 0, 0); PG8_LDB(B1, 0, 1); PG8_SCHED; PG8_LDA(At, 0, 0); PG8_STAGE(PG8_SA(1, 1), a1 + hstep, voffA);
            PG8_WAIT_V(8); PG8_WAIT_L(0); PG8_BAR; PG8_MMA(0, 0, At, B0); PG8_MMA(0, 1, At, B1); PG8_BAR; PG8_SCHED;
            PG8_LDA(At, 0, 1); PG8_STAGE(PG8_SB(0, 0), b2, voffB); PG8_STAGE(PG8_SB(0, 1), b2 + hstep, voffB); PG8_STAGE(PG8_SA(0, 0), a2, voffA);
            PG8_WAIT_V(8); PG8_WAIT_L(0); PG8_BAR; PG8_MMA(1, 0, At, B0); PG8_MMA(1, 1, At, B1); PG8_BAR; PG8_SCHED;
            PG8_LDB(B0, 1, 0); PG8_LDB(B1, 1, 1); PG8_SCHED; PG8_LDA(At, 1, 0); PG8_STAGE(PG8_SA(0, 1), a2 + hstep, voffA);
            PG8_WAIT_V(8); PG8_WAIT_L(0); PG8_BAR; PG8_MMA(0, 0, At, B0); PG8_MMA(0, 1, At, B1); PG8_BAR; PG8_SCHED;
            PG8_LDA(At, 1, 1); PG8_STAGE(PG8_SB(1, 0), b3, voffB); PG8_STAGE(PG8_SB(1, 1), b3 + hstep, voffB); PG8_STAGE(PG8_SA(1, 0), a3, voffA);
            PG8_WAIT_V(8); PG8_WAIT_L(0); PG8_BAR; PG8_MMA(1, 0, At, B0); PG8_MMA(1, 1, At, B1); PG8_BAR; PG8_SCHED;
            } else {
            PG8_LDB(B0, 0, 0); PG8_SCHED; PG8_LDA(At, 0, 0); PG8_STAGE(PG8_SA(1, 1), a1 + hstep, voffA);
            PG8_WAIT_L(8); PG8_BAR; PG8_WAIT_L(0); PG8_MMA(0, 0, At, B0); PG8_BAR; PG8_SCHED;
            PG8_LDB(B1, 0, 1); PG8_STAGE(PG8_SB(0, 0), b2, voffB);
            PG8_BAR; PG8_WAIT_L(0); PG8_MMA(0, 1, At, B1); PG8_BAR;
            PG8_LDA(At, 0, 1); PG8_STAGE(PG8_SA(0, 0), a2, voffA);
            PG8_BAR; PG8_WAIT_L(0); PG8_MMA(1, 0, At, B0); PG8_BAR; PG8_SCHED;
            PG8_STAGE(PG8_SB(0, 1), b2 + hstep, voffB);
            PG8_WAIT_V(6); PG8_BAR; PG8_MMA(1, 1, At, B1); PG8_BAR;
            PG8_LDB(B0, 1, 0); PG8_SCHED; PG8_LDA(At, 1, 0); PG8_STAGE(PG8_SA(0, 1), a2 + hstep, voffA);
            PG8_WAIT_L(8); PG8_BAR; PG8_WAIT_L(0); PG8_MMA(0, 0, At, B0); PG8_BAR; PG8_SCHED;
            PG8_LDB(B1, 1, 1); PG8_STAGE(PG8_SB(1, 0), b3, voffB);
            PG8_BAR; PG8_WAIT_L(0); PG8_MMA(0, 1, At, B1); PG8_BAR;
            PG8_LDA(At, 1, 1); PG8_STAGE(PG8_SA(1, 0), a3, voffA);
            PG8_BAR; PG8_WAIT_L(0); PG8_MMA(1, 0, At, B0); PG8_BAR; PG8_SCHED;
            PG8_STAGE(PG8_SB(1, 1), b3 + hstep, voffB);
            PG8_WAIT_V(6); PG8_BAR; PG8_MMA(1, 1, At, B1); PG8_BAR;
            }
        }
        if constexpr (ALIGN_EPI) { if (wr == 0) PG8_BAR; }
        if constexpr (!Epi::AFTER_DRAIN) { E(acc, cur, wr, wc, fr, fq); S.done(cur); }
        if (!has_next) break;
#pragma unroll
        for (int a = 0; a < 2; ++a)
#pragma unroll
            for (int b = 0; b < 2; ++b)
#pragma unroll
                for (int m = 0; m < 4; ++m)
#pragma unroll
                    for (int n = 0; n < 2; ++n) acc[a][b][m][n] = (f32x4){0.f, 0.f, 0.f, 0.f};
        cur = nxt; cA = nA; cB = nB; ++ui;
        if constexpr (ALIGN_EPI) { if (wr == 1) PG8_BAR; }
    }
    PG8_WAIT_V(0);
    if constexpr (!ALIGN_EPI) { if (wr == 0) PG8_BAR; }
    PG8_BAR;
    if constexpr (Epi::AFTER_DRAIN) { E.fused(acc, cur, wr, wc, fr, fq, lds, wid, lane); S.done(cur); }
#undef PG8_SA
#undef PG8_SB
#undef PG8_STAGE
#undef PG8_LDA
#undef PG8_LDB
#undef PG8_MMA
#undef PG8_WAIT_V
#undef PG8_WAIT_L
#undef PG8_BAR
#undef PG8_SCHED
}
}
namespace pg8 {
__device__ __forceinline__ float silu_f(float x) { return x * __builtin_amdgcn_rcpf(1.0f + __builtin_amdgcn_exp2f(-1.4426950408889634f * x)); }
__device__ __forceinline__ float bf_lo(unsigned w) { return __uint_as_float(w << 16); }
__device__ __forceinline__ float bf_hi(unsigned w) { return __uint_as_float(w & 0xffff0000u); }

struct EpiRetQKV {
    static constexpr bool PERM = true, AFTER_DRAIN = false;
    bf16_t* QK; bf16_t* V; const float* cs;
    __device__ __forceinline__ void operator()(const f32x4 (&acc)[2][2][4][2], const Unit& u, int wr, int wc, int fr, int fq) const {
        const int row0 = u.pm * BM + wr * 64 + fr;
        if (u.pn < 8) {
            const float sc = (u.pn >= 4) ? 0.0625f : 1.0f;
            const int col0 = u.pn * BM + wc * 32 + 8 * fq;
#pragma unroll
            for (int ai = 0; ai < 2; ++ai)
#pragma unroll
                for (int m = 0; m < 4; ++m) { const int row = row0 + ai * HALF + m * 16; const int t = row & 4095;
                    bf16_t* rowp = QK + (size_t)row * 2048 + col0;
#pragma unroll
                    for (int bj = 0; bj < 2; ++bj) {
                        const f32x4* cp = (const f32x4*)(cs + ((size_t)t * 128 + 64 * bj + 16 * wc + 4 * fq) * 2);
                        const f32x4 c01 = cp[0], c23 = cp[1];
                        const f32x4 v0 = acc[ai][bj][m][0], v1 = acc[ai][bj][m][1];
                        const float o0 = (v0[0] * c01[0] - v0[1] * c01[1]) * sc, o1 = (v0[0] * c01[1] + v0[1] * c01[0]) * sc;
                        const float o2 = (v0[2] * c01[2] - v0[3] * c01[3]) * sc, o3 = (v0[2] * c01[3] + v0[3] * c01[2]) * sc;
                        const float o4 = (v1[0] * c23[0] - v1[1] * c23[1]) * sc, o5 = (v1[0] * c23[1] + v1[1] * c23[0]) * sc;
                        const float o6 = (v1[2] * c23[2] - v1[3] * c23[3]) * sc, o7 = (v1[2] * c23[3] + v1[3] * c23[2]) * sc;
                        u32x4 w; w.x = cvt_pk_bf16(o0, o1); w.y = cvt_pk_bf16(o2, o3); w.z = cvt_pk_bf16(o4, o5); w.w = cvt_pk_bf16(o6, o7);
                        *(u32x4*)(rowp + bj * HALF) = w; } }
        } else {
            const int col0 = (u.pn - 8) * BM + wc * 32 + 8 * fq;
#pragma unroll
            for (int ai = 0; ai < 2; ++ai)
#pragma unroll
                for (int m = 0; m < 4; ++m) { bf16_t* rowp = V + (size_t)(row0 + ai * HALF + m * 16) * 2048 + col0;
#pragma unroll
                    for (int bj = 0; bj < 2; ++bj) { const f32x4 v0 = acc[ai][bj][m][0], v1 = acc[ai][bj][m][1];
                        u32x4 w; w.x = cvt_pk_bf16(v0[0], v0[1]); w.y = cvt_pk_bf16(v0[2], v0[3]); w.z = cvt_pk_bf16(v1[0], v1[1]); w.w = cvt_pk_bf16(v1[2], v1[3]);
                        *(u32x4*)(rowp + bj * HALF) = w; } }
        }
    }
};
struct EpiRetGate {
    static constexpr bool PERM = true, AFTER_DRAIN = false;
    bf16_t* Y; const float* stats; float eps;
    __device__ __forceinline__ void operator()(const f32x4 (&acc)[2][2][4][2], const Unit& u, int wr, int wc, int fr, int fq) const {
        const int row0 = u.pm * BM + wr * 64 + fr, head = u.pn >> 1, col0 = u.pn * BM + wc * 32 + 8 * fq;
#pragma unroll
        for (int ai = 0; ai < 2; ++ai)
#pragma unroll
            for (int m = 0; m < 4; ++m) { const int row = row0 + ai * HALF + m * 16;
                const f32x4* sp = (const f32x4*)(stats + ((size_t)row * 4 + head) * 16);
                const f32x4 a = sp[0], b = sp[1], c = sp[2], d = sp[3];
                const float s = ((a[0] + a[2]) + (b[0] + b[2])) + ((c[0] + c[2]) + (d[0] + d[2]));
                const float q = ((a[1] + a[3]) + (b[1] + b[3])) + ((c[1] + c[3]) + (d[1] + d[3]));
                const float mean = s * (1.0f / 512.0f); float var = q * (1.0f / 512.0f) - mean * mean; var = var < 0.f ? 0.f : var;
                const float rstd = 1.0f / sqrtf(var + eps);
                bf16_t* rowp = Y + (size_t)row * 2048 + col0;
#pragma unroll
                for (int bj = 0; bj < 2; ++bj) { const u32x4 yv = *(const u32x4*)(rowp + bj * HALF);
                    const f32x4 g0 = acc[ai][bj][m][0], g1 = acc[ai][bj][m][1];
                    const float o0 = silu_f(g0[0]) * ((bf_lo(yv.x) - mean) * rstd), o1 = silu_f(g0[1]) * ((bf_hi(yv.x) - mean) * rstd);
                    const float o2 = silu_f(g0[2]) * ((bf_lo(yv.y) - mean) * rstd), o3 = silu_f(g0[3]) * ((bf_hi(yv.y) - mean) * rstd);
                    const float o4 = silu_f(g1[0]) * ((bf_lo(yv.z) - mean) * rstd), o5 = silu_f(g1[1]) * ((bf_hi(yv.z) - mean) * rstd);
                    const float o6 = silu_f(g1[2]) * ((bf_lo(yv.w) - mean) * rstd), o7 = silu_f(g1[3]) * ((bf_hi(yv.w) - mean) * rstd);
                    u32x4 w; w.x = cvt_pk_bf16(o0, o1); w.y = cvt_pk_bf16(o2, o3); w.z = cvt_pk_bf16(o4, o5); w.w = cvt_pk_bf16(o6, o7);
                    *(u32x4*)(rowp + bj * HALF) = w; } }
    }
};
struct EpiResid {
    static constexpr bool PERM = false, AFTER_DRAIN = false;
    const float* base; float* out; float alpha;
    __device__ __forceinline__ void operator()(const f32x4 (&acc)[2][2][4][2], const Unit& u, int wr, int wc, int fr, int fq) const {
        const int row0 = u.pm * BM + wr * 64 + fr, col0 = u.pn * BM + wc * 32 + 4 * fq;
#pragma unroll
        for (int ai = 0; ai < 2; ++ai)
#pragma unroll
            for (int m = 0; m < 4; ++m) { const size_t off = (size_t)(row0 + ai * HALF + m * 16) * 1024 + col0;
                f32x4 bv[2][2];
#pragma unroll
                for (int bj = 0; bj < 2; ++bj)
#pragma unroll
                    for (int n = 0; n < 2; ++n) bv[bj][n] = *(const f32x4*)(base + off + bj * HALF + n * 16);
#pragma unroll
                for (int bj = 0; bj < 2; ++bj)
#pragma unroll
                    for (int n = 0; n < 2; ++n) *(f32x4*)(out + off + bj * HALF + n * 16) = bv[bj][n] * alpha + acc[ai][bj][m][n]; }
    }
};
struct EpiSwiglu {
    static constexpr bool PERM = true, AFTER_DRAIN = false;
    bf16_t* H; int ldh;
    __device__ __forceinline__ void operator()(const f32x4 (&acc)[2][2][4][2], const Unit& u, int wr, int wc, int fr, int fq) const {
        const int row0 = u.pm * BM + wr * 64 + fr, col0 = u.pn * HALF + wc * 32 + 8 * fq;
#pragma unroll
        for (int ai = 0; ai < 2; ++ai)
#pragma unroll
            for (int m = 0; m < 4; ++m) { bf16_t* p = H + (size_t)(row0 + ai * HALF + m * 16) * ldh + col0;
                const f32x4 g0 = acc[ai][0][m][0], g1 = acc[ai][0][m][1], u0 = acc[ai][1][m][0], u1 = acc[ai][1][m][1];
                u32x4 w; w.x = cvt_pk_bf16(silu_f(g0[0]) * u0[0], silu_f(g0[1]) * u0[1]); w.y = cvt_pk_bf16(silu_f(g0[2]) * u0[2], silu_f(g0[3]) * u0[3]);
                w.z = cvt_pk_bf16(silu_f(g1[0]) * u1[0], silu_f(g1[1]) * u1[1]); w.w = cvt_pk_bf16(silu_f(g1[2]) * u1[2], silu_f(g1[3]) * u1[3]);
                *(u32x4*)p = w; }
    }
};
}
namespace ret {
typedef short bf16x8 __attribute__((ext_vector_type(8)));
typedef short s16x4 __attribute__((ext_vector_type(4)));
typedef float f32x4 __attribute__((ext_vector_type(4)));
typedef unsigned u32x4 __attribute__((ext_vector_type(4)));
typedef unsigned u32x2 __attribute__((ext_vector_type(2)));
#define RLAS __attribute__((address_space(3)))
constexpr int KS = 528, VS = 144, SS = 528;
constexpr int OFF_K = 0, OFF_V = 128 * KS, OFF_ST = OFF_V + 128 * VS, LDS_END = OFF_ST + 64 * SS;
__device__ __forceinline__ s16x4 trd(const RLAS unsigned char* p) { return __builtin_bit_cast(s16x4, __builtin_amdgcn_ds_read_tr16_b64_v4i16((RLAS s16x4*)p)); }
__device__ __forceinline__ bf16x8 cat8(s16x4 lo, s16x4 hi) { return (bf16x8){lo[0], lo[1], lo[2], lo[3], hi[0], hi[1], hi[2], hi[3]}; }
__device__ __forceinline__ unsigned pkbf(float lo, float hi) { unsigned r; asm volatile("v_cvt_pk_bf16_f32 %0, %1, %2" : "=v"(r) : "v"(lo), "v"(hi)); return r; }
__device__ __forceinline__ float blo(unsigned w) { return __uint_as_float(w << 16); }
__device__ __forceinline__ float bhi(unsigned w) { return __uint_as_float(w & 0xffff0000u); }

__device__ __forceinline__ void ret_unit(int b, int h, int sl, const unsigned short* QK, unsigned short* V, float* stats, RLAS unsigned char* lds, const int tid) {
    const int lane = tid & 63, w = __builtin_amdgcn_readfirstlane(tid >> 6), c = lane & 15, q = lane >> 4;
    const int qb = (w < 4) ? w : 11 - w;
    const float gamma = 1.0f - exp2f(-5.0f - (float)h), lg2 = log2f(gamma);
    const float gC = exp2f(128.0f * lg2);
    const size_t rowb = (size_t)b * 4096;
    const unsigned short* Qg = QK + rowb * 2048 + h * 256;
    const unsigned short* Kg = QK + rowb * 2048 + 1024 + h * 256;
    unsigned short* Vg = V + rowb * 2048 + h * 512 + sl * 64;
    float* stg = stats + (rowb * 4 + h) * 16 + sl * 2;
    f32x4 st[2][4];
#pragma unroll
    for (int a = 0; a < 2; ++a)
#pragma unroll
        for (int e = 0; e < 4; ++e) st[a][e] = (f32x4){0.f, 0.f, 0.f, 0.f};
    for (int i = tid; i < 64 * SS / 16; i += 512) *(RLAS u32x4*)(lds + OFF_ST + i * 16) = (u32x4){0u, 0u, 0u, 0u};
    u32x4 kpre[8], vpre[2]; bf16x8 qf[8];
    const unsigned koff = (unsigned)(((tid >> 5) * 2048 + (tid & 31) * 8) * 2), voff = (unsigned)(((tid >> 3) * 2048 + (tid & 7) * 8) * 2);
#define RET_LOADKV(n) do { const size_t r0_ = (size_t)(n) * 128; \
        _Pragma("unroll") for (int i = 0; i < 8; ++i) kpre[i] = *(const u32x4*)((const char*)(Kg + (r0_ + 16 * i) * 2048) + koff); \
        _Pragma("unroll") for (int i = 0; i < 2; ++i) vpre[i] = *(const u32x4*)((const char*)(Vg + (r0_ + 64 * i) * 2048) + voff); } while (0)
#define RET_LOADQ(dst, n) do { const unsigned short* qp_ = Qg + ((size_t)(n) * 128 + 16 * qb + c) * 2048 + 8 * q; \
        _Pragma("unroll") for (int ks = 0; ks < 8; ++ks) dst[ks] = *(const bf16x8*)(qp_ + 32 * ks); } while (0)
#define RET_STOREKV() do { \
        _Pragma("unroll") for (int i = 0; i < 8; ++i) { const int p = tid + 512 * i; *(RLAS u32x4*)(lds + OFF_K + (p >> 5) * KS + (p & 31) * 16) = kpre[i]; } \
        _Pragma("unroll") for (int i = 0; i < 2; ++i) { const int p = tid + 512 * i; const int j = p >> 3; const float f = exp2f(-(float)(j + 1) * lg2); const u32x4 v = vpre[i]; u32x4 o; \
            o.x = pkbf(blo(v.x) * f, bhi(v.x) * f); o.y = pkbf(blo(v.y) * f, bhi(v.y) * f); o.z = pkbf(blo(v.z) * f, bhi(v.z) * f); o.w = pkbf(blo(v.w) * f, bhi(v.w) * f); \
            *(RLAS u32x4*)(lds + OFF_V + j * VS + (p & 7) * 16) = o; } } while (0)
    RET_LOADKV(0); RET_LOADQ(qf, 0);
    RET_STOREKV();
    __syncthreads();
    const RLAS unsigned char* kimg = lds + OFF_K; const RLAS unsigned char* vimg = lds + OFF_V; const RLAS unsigned char* simg = lds + OFF_ST;
    const int tro = (c >> 2), tcol = 4 * (c & 3);
    for (int n = 0; n < 32; ++n) {
        const bool more = (n + 1 < 32);
        u32x2 P[8];
#pragma unroll
        for (int jb = 0; jb < 8; ++jb) {
            P[jb] = (u32x2){0u, 0u};
            if (jb <= qb) {
                f32x4 a = (f32x4){0.f, 0.f, 0.f, 0.f};
#pragma unroll
                for (int ks = 0; ks < 8; ++ks) { const bf16x8 kf = *(const RLAS bf16x8*)(kimg + (16 * jb + c) * KS + (32 * ks + 8 * q) * 2);
                    a = __builtin_amdgcn_mfma_f32_16x16x32_bf16(kf, qf[ks], a, 0, 0, 0); }
                if (jb == qb) {
#pragma unroll
                    for (int r = 0; r < 4; ++r) if (4 * q + r > c) a[r] = 0.f; }
                P[jb].x = pkbf(a[0], a[1]); P[jb].y = pkbf(a[2], a[3]);
            }
        }
        f32x4 y[4];
#pragma unroll
        for (int e = 0; e < 4; ++e) y[e] = (f32x4){0.f, 0.f, 0.f, 0.f};
#pragma unroll
        for (int kk = 0; kk < 4; ++kk) {
            if (2 * kk <= qb) {
                const u32x4 bw = (u32x4){P[2 * kk].x, P[2 * kk].y, P[2 * kk + 1].x, P[2 * kk + 1].y};
                const bf16x8 bfr = __builtin_bit_cast(bf16x8, bw);
#pragma unroll
                for (int e = 0; e < 4; ++e) { const RLAS unsigned char* vp = vimg + (32 * kk + 4 * q + tro) * VS + (16 * e + tcol) * 2;
                    const bf16x8 vf = cat8(trd(vp), trd(vp + 16 * VS));
                    y[e] = __builtin_amdgcn_mfma_f32_16x16x32_bf16(vf, bfr, y[e], 0, 0, 0); }
            }
        }
#pragma unroll
        for (int ks = 0; ks < 8; ++ks) {
#pragma unroll
            for (int e = 0; e < 4; ++e) { const bf16x8 sf = *(const RLAS bf16x8*)(simg + (16 * e + c) * SS + (32 * ks + 8 * q) * 2);
                y[e] = __builtin_amdgcn_mfma_f32_16x16x32_bf16(sf, qf[ks], y[e], 0, 0, 0); }
        }
        asm volatile("" ::: "memory");
        if (more) { RET_LOADKV(n + 1); RET_LOADQ(qf, n + 1); }
        asm volatile("" ::: "memory");
        {
            const int il = 16 * qb + c; const float fac = exp2f((float)(il + 1) * lg2);
            float s = 0.f, s2 = 0.f;
            unsigned short* yp = Vg + ((size_t)n * 128 + il) * 2048 + 4 * q;
#pragma unroll
            for (int e = 0; e < 4; ++e) { const f32x4 v = y[e] * fac; s += (v[0] + v[1]) + (v[2] + v[3]); s2 += (v[0] * v[0] + v[1] * v[1]) + (v[2] * v[2] + v[3] * v[3]);
                u32x2 o; o.x = pkbf(v[0], v[1]); o.y = pkbf(v[2], v[3]); *(u32x2*)(yp + 16 * e) = o; }
            s += __shfl_xor(s, 16); s += __shfl_xor(s, 32); s2 += __shfl_xor(s2, 16); s2 += __shfl_xor(s2, 32);
            if (q == 0) { float2 o2; o2.x = s; o2.y = s2; *(float2*)(stg + ((size_t)n * 128 + il) * 64) = o2; }
        }
#pragma unroll
        for (int kk = 0; kk < 4; ++kk) {
            bf16x8 vf[4], kf[2];
#pragma unroll
            for (int e = 0; e < 4; ++e) { const RLAS unsigned char* vp = vimg + (32 * kk + 4 * q + tro) * VS + (16 * e + tcol) * 2; vf[e] = cat8(trd(vp), trd(vp + 16 * VS)); }
#pragma unroll
            for (int a = 0; a < 2; ++a) { const RLAS unsigned char* kp = kimg + (32 * kk + 4 * q + tro) * KS + (16 * (2 * w + a) + tcol) * 2; kf[a] = cat8(trd(kp), trd(kp + 16 * KS)); }
#pragma unroll
            for (int a = 0; a < 2; ++a)
#pragma unroll
                for (int e = 0; e < 4; ++e) st[a][e] = __builtin_amdgcn_mfma_f32_16x16x32_bf16(kf[a], vf[e], st[a][e], 0, 0, 0);
        }
#pragma unroll
        for (int a = 0; a < 2; ++a)
#pragma unroll
            for (int e = 0; e < 4; ++e) st[a][e] = st[a][e] * gC;
        __syncthreads();
#pragma unroll
        for (int a = 0; a < 2; ++a)
#pragma unroll
            for (int e = 0; e < 4; ++e) { u32x2 o; o.x = pkbf(st[a][e][0], st[a][e][1]); o.y = pkbf(st[a][e][2], st[a][e][3]);
                *(RLAS u32x2*)(lds + OFF_ST + (16 * e + c) * SS + (16 * (2 * w + a) + 4 * q) * 2) = o; }
        if (more) { RET_STOREKV(); }
        __syncthreads();
    }
#undef RET_LOADKV
#undef RET_LOADQ
#undef RET_STOREKV
}
__device__ __forceinline__ void ret_phase(int vcu, int G, const unsigned short* QK, unsigned short* V, float* stats, RLAS unsigned char* lds, const int tid) {
    for (int u = vcu; u < 256; u += G) { const int bh = u >> 3; ret_unit(bh >> 2, bh & 3, u & 7, QK, V, stats, lds, tid); __syncthreads(); }
}
#undef RLAS
}
namespace att {
typedef short bf16x8 __attribute__((ext_vector_type(8)));
typedef short s16x4 __attribute__((ext_vector_type(4)));
typedef float f32x16 __attribute__((ext_vector_type(16)));
typedef unsigned u32x4 __attribute__((ext_vector_type(4)));
#define ALAS __attribute__((address_space(3)))
constexpr int RS = 144;
constexpr int OFF_K = 0, OFF_V = 384 * RS, OFF_B = 2 * 384 * RS, OFF_WS = OFF_B + 192 * 4, LDS_END = OFF_WS + 8 * 256;
constexpr int BT_STRIDE = 192;
__device__ __forceinline__ s16x4 trd(const ALAS unsigned char* p) { return __builtin_bit_cast(s16x4, __builtin_amdgcn_ds_read_tr16_b64_v4i16((ALAS s16x4*)p)); }
__device__ __forceinline__ bf16x8 cat8(s16x4 lo, s16x4 hi) { return (bf16x8){lo[0], lo[1], lo[2], lo[3], hi[0], hi[1], hi[2], hi[3]}; }
__device__ __forceinline__ unsigned pkbf(float lo, float hi) { unsigned r; asm volatile("v_cvt_pk_bf16_f32 %0, %1, %2" : "=v"(r) : "v"(lo), "v"(hi)); return r; }
__device__ __forceinline__ int crow(int r, int hi) { return (r & 3) + 8 * (r >> 2) + 4 * hi; }

__device__ __forceinline__ void att_unit(int g, int b, int h, int r, int n2, const unsigned short* QKV, unsigned short* OA, float* LSE, const float* btab, ALAS unsigned char* lds, const int tid) {
    const int lane = tid & 63, w = __builtin_amdgcn_readfirstlane(tid >> 6), ql = lane & 31, hi = lane >> 5;
    const int dsh = 2 * g;
    const size_t MS = (size_t)32768 * 1024;
    const unsigned short* Qg = QKV; const unsigned short* Kg = QKV + MS; const unsigned short* Vg = QKV + 2 * MS;
    const size_t rowb = (size_t)b * 4096;
    const int s0 = 256 * n2;
#pragma unroll
    for (int i = 0; i < 6; ++i) { const int p = tid + 512 * i, br = p >> 3, ch = p & 7; const int s = s0 - 128 + br;
        u32x4 kv = (u32x4){0u, 0u, 0u, 0u}, vv = (u32x4){0u, 0u, 0u, 0u};
        if (s >= 0) { const size_t off = (rowb + ((size_t)s << dsh) + r) * 1024 + h * 64 + ch * 8; kv = *(const u32x4*)(Kg + off); vv = *(const u32x4*)(Vg + off); }
        *(ALAS u32x4*)(lds + OFF_K + br * RS + ch * 16) = kv; *(ALAS u32x4*)(lds + OFF_V + br * RS + ch * 16) = vv; }
    if (tid < BT_STRIDE) ((ALAS float*)(lds + OFF_B))[tid] = btab[(g * 16 + h) * BT_STRIDE + tid];
    bf16x8 qf[4];
    { const unsigned short* qp = Qg + (rowb + ((size_t)(s0 + 32 * w + ql) << dsh) + r) * 1024 + h * 64 + 8 * hi;
#pragma unroll
      for (int ks = 0; ks < 4; ++ks) qf[ks] = *(const bf16x8*)(qp + 16 * ks); }
    __syncthreads();
    const ALAS unsigned char* kimg = lds + OFF_K; const ALAS unsigned char* vimg = lds + OFF_V; const ALAS float* bl = (const ALAS float*)(lds + OFF_B);
    ALAS float* wsf = (ALAS float*)(lds + OFF_WS + w * 256);
    f32x16 S[5];
    float mx = -INFINITY;
#pragma unroll
    for (int st = 0; st < 5; ++st) {
        f32x16 a = {};
#pragma unroll
        for (int ks = 0; ks < 4; ++ks) { const bf16x8 kf = *(const ALAS bf16x8*)(kimg + (32 * (w + st) + ql) * RS + (16 * ks + 8 * hi) * 2);
            a = __builtin_amdgcn_mfma_f32_32x32x16_bf16(kf, qf[ks], a, 0, 0, 0); }
#pragma unroll
        for (int rg = 0; rg < 16; ++rg) { const int kr = crow(rg, hi); const int delta = ql - kr + 128 - 32 * st; const int ks_abs = s0 + 32 * (w + st) - 128 + kr;
            const bool ok = (delta >= 0) && (delta <= 128) && (ks_abs >= 0);
            const float v = ok ? a[rg] + bl[delta + 32] : -INFINITY; a[rg] = v; mx = fmaxf(mx, v); }
        S[st] = a;
    }
    mx = fmaxf(mx, __shfl_xor(mx, 32));
    float l = 0.f;
#pragma unroll
    for (int st = 0; st < 5; ++st)
#pragma unroll
        for (int rg = 0; rg < 16; ++rg) { const float p = __builtin_amdgcn_exp2f(S[st][rg] - mx); S[st][rg] = p; l += p; }
    l += __shfl_xor(l, 32);
    if (hi == 0) { wsf[ql] = l; wsf[32 + ql] = mx; }
    f32x16 O[2]; O[0] = f32x16{}; O[1] = f32x16{};
    const int c16 = lane & 15, g16 = (lane >> 4) & 1;
#pragma unroll
    for (int st = 0; st < 5; ++st)
#pragma unroll
        for (int s2 = 0; s2 < 2; ++s2) {
            u32x4 pw; pw.x = pkbf(S[st][8 * s2 + 0], S[st][8 * s2 + 1]); pw.y = pkbf(S[st][8 * s2 + 2], S[st][8 * s2 + 3]); pw.z = pkbf(S[st][8 * s2 + 4], S[st][8 * s2 + 5]); pw.w = pkbf(S[st][8 * s2 + 6], S[st][8 * s2 + 7]);
            const bf16x8 pa = __builtin_bit_cast(bf16x8, pw);
#pragma unroll
            for (int db = 0; db < 2; ++db) { const ALAS unsigned char* vp = vimg + (32 * (w + st) + 16 * s2 + 4 * hi + (c16 >> 2)) * RS + (32 * db + 16 * g16 + 4 * (c16 & 3)) * 2;
                const bf16x8 vf = cat8(trd(vp), trd(vp + 8 * RS));
                O[db] = __builtin_amdgcn_mfma_f32_32x32x16_bf16(pa, vf, O[db], 0, 0, 0); }
        }
    asm volatile("s_waitcnt lgkmcnt(0)" ::: "memory");
#pragma unroll
    for (int rg = 0; rg < 16; ++rg) { const int qr = crow(rg, hi); const float lq = wsf[qr], mq = wsf[32 + qr];
        const size_t row = rowb + ((size_t)(s0 + 32 * w + qr) << dsh) + r;
        const float il = 1.0f / lq; float o0 = O[0][rg] * il, o1 = O[1][rg] * il; float lse = mq + log2f(lq);
        unsigned short* op = OA + row * 1024 + h * 64 + ql;
        if (g > 0) { const float lo = LSE[row * 16 + h]; const float a0 = __uint_as_float((unsigned)op[0] << 16), a1 = __uint_as_float((unsigned)op[32] << 16);
            const float m2 = fmaxf(lo, lse), wa = __builtin_amdgcn_exp2f(lo - m2), wb = __builtin_amdgcn_exp2f(lse - m2), ws = wa + wb, iw = 1.0f / ws;
            o0 = (wa * a0 + wb * o0) * iw; o1 = (wa * a1 + wb * o1) * iw; lse = m2 + log2f(ws); }
        const unsigned pk = pkbf(o0, o1);
        op[0] = (unsigned short)(pk & 0xffffu); op[32] = (unsigned short)(pk >> 16);
        if (ql == 0) LSE[row * 16 + h] = lse; }
    __syncthreads();
}
__device__ __forceinline__ void att_phase(int g, int vcu, int G, const unsigned short* QKV, unsigned short* OA, float* LSE, const float* btab, ALAS unsigned char* lds, const int tid) {
    for (int u = vcu; u < 2048; u += G) { const int bh = u >> 4, rem = u & 15; const int r = (g == 0) ? 0 : (g == 1) ? (rem >> 2) : rem; const int n2 = (g == 0) ? rem : (g == 1) ? (rem & 3) : 0;
        att_unit(g, bh >> 4, bh & 15, r, n2, QKV, OA, LSE, btab, lds, tid); }
}
#undef ALAS
}
#define GAS __attribute__((address_space(1)))
#define LAS __attribute__((address_space(3)))
typedef unsigned short bf16;
typedef unsigned v4u __attribute__((ext_vector_type(4)));
typedef float f32x4 __attribute__((ext_vector_type(4)));
typedef short bf16x8 __attribute__((ext_vector_type(8)));
typedef GAS unsigned gu32;
typedef GAS unsigned long long gu64;
#define RLX_AGENT __ATOMIC_RELAXED, __HIP_MEMORY_SCOPE_AGENT
#define LDS_WAIT() asm volatile("s_waitcnt lgkmcnt(0)" ::: "memory")
#define VM_WAIT() asm volatile("s_waitcnt vmcnt(0)" ::: "memory")
__device__ __forceinline__ unsigned long long rt() { return __builtin_amdgcn_s_memrealtime(); }
__device__ __forceinline__ unsigned f2bf(float f) { unsigned u = __builtin_bit_cast(unsigned, f); return (u + 0x7fffu + ((u >> 16) & 1u)) >> 16; }
__device__ __forceinline__ unsigned pk2(float lo, float hi) { return f2bf(lo) | (f2bf(hi) << 16); }

#define XB_TMO      128
#define XB_XCNT(j)  (256  + 64 * (j))
#define XB_XSUB(j)  (1280 + 64 * (j))
#define XB_XGEN(j)  (2304 + 64 * (j))
#define XB_TOP      3328
#define XB_TOPGEN   3392
#define XCD_BAR_WORDS 3456
#define XB_SPIN_CAP (1u << 18)

__device__ __forceinline__ unsigned xb_ld(unsigned* p)              { return __hip_atomic_load(p, __ATOMIC_RELAXED, __HIP_MEMORY_SCOPE_AGENT); }
__device__ __forceinline__ unsigned xb_add(unsigned* p, unsigned v) { return __hip_atomic_fetch_add(p, v, __ATOMIC_RELAXED, __HIP_MEMORY_SCOPE_AGENT); }
__device__ __forceinline__ unsigned xb_xcc_id() { return (unsigned)__builtin_amdgcn_s_getreg((3 << 11) | 20) & 0xFu; }
#define XB_SPIN(cond, bar) do { unsigned _sp = 0; while (cond) { __builtin_amdgcn_s_sleep(1); \
    if ((++_sp & 255u) == 0u) { if (xb_ld(&(bar)[XB_TMO])) break; if (_sp > XB_SPIN_CAP) { atomicAdd(&(bar)[XB_TMO], 1u); break; } } } } while (0)

struct XcdBarrier {
    unsigned* bar; unsigned x;
    volatile LAS unsigned* st;
};

__device__ __forceinline__ XcdBarrier xcd_barrier_post(unsigned* bar, volatile LAS unsigned* st) {
    XcdBarrier b; b.bar = bar; b.x = xb_xcc_id(); b.st = st;
    if (threadIdx.x == 0) (void)xb_add(&bar[XB_XCNT(b.x)], 1u);
    return b;
}
__device__ __forceinline__ void xcd_barrier_complete(unsigned* bar, unsigned x, unsigned& nloc, unsigned& nx) {
    const unsigned G = gridDim.x * gridDim.y * gridDim.z;
    unsigned sum, cnt, mine, sp = 0u;
    for (;;) {
        sum = 0u; cnt = 0u; mine = 0u;
#pragma unroll
        for (unsigned j = 0; j < 16; ++j) { const unsigned c = xb_ld(&bar[XB_XCNT(j)]); sum += c; cnt += (c > 0u) ? 1u : 0u; mine = (j == x) ? c : mine; }
        if (sum == G) break;
        __builtin_amdgcn_s_sleep(1);
        if ((++sp & 255u) == 0u) { if (xb_ld(&bar[XB_TMO])) break; if (sp > XB_SPIN_CAP) { atomicAdd(&bar[XB_TMO], 1u); break; } }
    }
    nloc = mine > 0u ? mine : 1u; nx = cnt > 0u ? cnt : 1u;
}

__device__ __forceinline__ void xcd_barrier(const XcdBarrier& b) {
    asm volatile("s_waitcnt vmcnt(0)" ::: "memory");
    __syncthreads();
    if (threadIdx.x == 0) {
        unsigned* bar = b.bar;
        __builtin_amdgcn_s_waitcnt(0);
        unsigned nloc = b.st[0], nx = b.st[1];
        if (nloc == 0u) { xcd_barrier_complete(bar, b.x, nloc, nx); b.st[0] = nloc; b.st[1] = nx; }
        const unsigned old = xb_add(&bar[XB_XSUB(b.x)], 1u);
        const unsigned gen = old / nloc;
        if (old + 1u == (gen + 1u) * nloc) {
            __builtin_amdgcn_fence(__ATOMIC_RELEASE, "agent");
            asm volatile("s_waitcnt vmcnt(0)" ::: "memory");
            const unsigned og = xb_add(&bar[XB_TOP], 1u);
            const unsigned tg = og / nx;
            if (og + 1u == (tg + 1u) * nx) xb_add(&bar[XB_TOPGEN], 1u);
            else XB_SPIN(xb_ld(&bar[XB_TOPGEN]) == tg, bar);
            __builtin_amdgcn_fence(__ATOMIC_ACQUIRE, "agent");
            xb_add(&bar[XB_XGEN(b.x)], 1u);
            asm volatile("s_waitcnt vmcnt(0)" ::: "memory");
        } else {
            XB_SPIN(xb_ld(&bar[XB_XGEN(b.x)]) == gen, bar);
            __builtin_amdgcn_fence(__ATOMIC_ACQUIRE, "agent");
            asm volatile("s_waitcnt vmcnt(0)" ::: "memory");
        }
    }
    __syncthreads();
}
constexpr int NWAVES = 8;
constexpr int BATCH = 8, T = 4096, D = 1024, M = BATCH * T, DEPTH = 4;
constexpr int RET_IN = 6144, RET_V = 2048, ATT_IN = 9216, FF = 2816, FF2 = 5632;
constexpr float LN_EPS = 1e-5f, GN_EPS = 1e-5f;
constexpr float DN_ALPHA = 1.6817928305074290f;
constexpr float LOG2E = 1.4426950408889634f;
constexpr size_t MiB = 1u << 20;
constexpr size_t WS_CTL = 0, CTL_ZERO_BYTES = 1 * MiB;
constexpr size_t WS_ROPE = 1 * MiB;
constexpr size_t WS_BT = 5 * MiB;
constexpr size_t WS_WRI = 6 * MiB;
constexpr size_t WS_WRO = 30 * MiB;
constexpr size_t WS_WAI = 38 * MiB;
constexpr size_t WS_WAO = 74 * MiB;
constexpr size_t WS_WUP = 78 * MiB;
constexpr size_t WS_WDN = 122 * MiB;
constexpr size_t WS_XB = 144 * MiB;
constexpr size_t WS_ACT = 208 * MiB;
constexpr size_t WS_QK = WS_ACT, WS_V = WS_ACT + 128 * MiB, WS_ST = WS_ACT + 256 * MiB;
constexpr size_t WS_QKV = WS_ACT, WS_OA = WS_ACT + 192 * MiB, WS_LSE = WS_ACT + 256 * MiB;
constexpr size_t WS_H = WS_ACT;
constexpr size_t WS_END = 472 * MiB;
constexpr int CW_TMO = 0, CW_CODE = 1, CW_BAR = 4096;
constexpr int RING_OFF = 0, RING_BYTES = 131072;
constexpr int LDSCTL_OFF = RING_BYTES, MISC_OFF = LDSCTL_OFF + 320;
constexpr int LDS_BYTES = 147456;
static_assert(ret::LDS_END <= RING_BYTES && att::LDS_END <= RING_BYTES, "phase scratch fits the ring region");

__device__ __forceinline__ float wave_sum(float v) {
#pragma unroll
    for (int o = 1; o < 64; o <<= 1) v += __shfl_xor(v, o);
    return v;
}
__device__ __forceinline__ void p0_transpose_item(const float* W, int K, int N, bf16* WT, int k0, int n0, int drow0, LAS float* scr, int lane) {
#pragma unroll 8
    for (int i = 0; i < 32; ++i) { const int kk = 2 * i + (lane >> 5); scr[kk * 33 + (lane & 31)] = W[(size_t)(k0 + kk) * N + n0 + (lane & 31)]; }
    LDS_WAIT(); asm volatile("" ::: "memory");
    const int c = lane & 7;
#pragma unroll
    for (int j = 0; j < 4; ++j) { const int n = (lane >> 3) + 8 * j; const LAS float* s = scr + (8 * c) * 33 + n;
        v4u o; o.x = pk2(s[0 * 33], s[1 * 33]); o.y = pk2(s[2 * 33], s[3 * 33]); o.z = pk2(s[4 * 33], s[5 * 33]); o.w = pk2(s[6 * 33], s[7 * 33]);
        *(GAS v4u*)(WT + (size_t)(drow0 + n) * K + k0 + 8 * c) = o; }
    LDS_WAIT(); asm volatile("" ::: "memory");
}
#ifndef PH
#define PH 0xffff
#endif
struct Args { const float* in[10]; float* out; unsigned char* ws; };

__device__ __forceinline__ int t5_bucket(int dist) {
    if (dist < 16) return dist;
    int large = 16 + (int)(log((double)dist / 16.0) / log(128.0) * 16.0);
    return large < 31 ? large : 31;
}

__global__ void __launch_bounds__(NWAVES * 64, 2) mk_fwd(Args args) {
    extern __shared__ __attribute__((aligned(16))) unsigned char lds_raw[];
    LAS unsigned char* lds = (LAS unsigned char*)lds_raw;
    volatile LAS unsigned* MISC = (volatile LAS unsigned*)(lds + MISC_OFF);
    const int tid = threadIdx.x, lane = tid & 63, wave = __builtin_amdgcn_readfirstlane(tid >> 6);
    const int G = gridDim.x; const int bx = blockIdx.x; const int vcu = (G % 8 == 0) ? (bx % 8) * (G / 8) + bx / 8 : bx;
    unsigned char* ws = args.ws;
    gu32* ctl = (gu32*)(ws + WS_CTL);
    const float* x_in = args.in[0]; const float* ret_w_in = args.in[1]; const float* ret_w_out = args.in[2]; const float* attn_w_in = args.in[3]; const float* attn_w_out = args.in[4];
    const float* rel_bias = args.in[5]; const float* ffn_w_up = args.in[6]; const float* ffn_w_down = args.in[7]; const float* ln_gain = args.in[8]; const float* ln_bias = args.in[9];
    float* X = args.out;
    float* rope = (float*)(ws + WS_ROPE); float* btab = (float*)(ws + WS_BT);
    bf16* WRI = (bf16*)(ws + WS_WRI); bf16* WRO = (bf16*)(ws + WS_WRO); bf16* WAI = (bf16*)(ws + WS_WAI); bf16* WAO = (bf16*)(ws + WS_WAO); bf16* WUP = (bf16*)(ws + WS_WUP); bf16* WDN = (bf16*)(ws + WS_WDN);
    bf16* XB = (bf16*)(ws + WS_XB); bf16* QK = (bf16*)(ws + WS_QK); bf16* VB = (bf16*)(ws + WS_V); float* STATS = (float*)(ws + WS_ST);
    bf16* QKV = (bf16*)(ws + WS_QKV); bf16* OA = (bf16*)(ws + WS_OA); float* LSE = (float*)(ws + WS_LSE); bf16* HB = (bf16*)(ws + WS_H);
    for (int u = tid; u < (LDS_BYTES - LDSCTL_OFF) / 4; u += NWAVES * 64) ((LAS unsigned*)(lds + LDSCTL_OFF))[u] = 0u;
    __syncthreads();
    XcdBarrier bar = xcd_barrier_post((unsigned*)(ctl + CW_BAR), MISC + 8);
#define GRID_BAR() xcd_barrier(bar)
#define OPQ_TID() ({ int t_ = (int)threadIdx.x; asm volatile("" : "+v"(t_)); t_; })
    const int gw = vcu * NWAVES + wave, NGW = G * NWAVES;

#if PH & 1
    {
        LAS float* scr = (LAS float*)(lds + RING_OFF + wave * 16384);
        constexpr int I_RI = 16 * 192, I_RO = 32 * 32, I_AI = 16 * 288, I_AO = 16 * 32, I_UP = 16 * 176, I_DN = 44 * 32;
        constexpr int NITEMS = 2 * (I_RI + I_RO + I_AI + I_AO) + 4 * (I_UP + I_DN);
        for (int it = gw; it < NITEMS; it += NGW) {
            int r = it;
            if (r < 2 * I_RI) { const int j = r / I_RI; r -= j * I_RI; const int nb = r % 192, kb = r / 192;
                p0_transpose_item(ret_w_in + (size_t)j * 1024 * RET_IN, 1024, RET_IN, WRI + (size_t)j * RET_IN * 1024, 64 * kb, 32 * nb, 32 * nb, scr, lane); continue; } r -= 2 * I_RI;
            if (r < 2 * I_RO) { const int j = r / I_RO; r -= j * I_RO; const int nb = r % 32, kb = r / 32;
                p0_transpose_item(ret_w_out + (size_t)j * RET_V * 1024, RET_V, 1024, WRO + (size_t)j * 1024 * RET_V, 64 * kb, 32 * nb, 32 * nb, scr, lane); continue; } r -= 2 * I_RO;
            if (r < 2 * I_AI) { const int j = r / I_AI; r -= j * I_AI; const int nb = r % 288, kb = r / 288; const int n0 = 32 * nb;
                const int s = n0 / 3072, g = (n0 / 1024) % 3, hd = n0 % 1024; const int drow = (g * 3 + s) * 1024 + hd;
                p0_transpose_item(attn_w_in + (size_t)j * 1024 * ATT_IN, 1024, ATT_IN, WAI + (size_t)j * ATT_IN * 1024, 64 * kb, n0, drow, scr, lane); continue; } r -= 2 * I_AI;
            if (r < 2 * I_AO) { const int j = r / I_AO; r -= j * I_AO; const int nb = r % 32, kb = r / 32;
                p0_transpose_item(attn_w_out + (size_t)j * 1024 * 1024, 1024, 1024, WAO + (size_t)j * 1024 * 1024, 64 * kb, 32 * nb, 32 * nb, scr, lane); continue; } r -= 2 * I_AO;
            if (r < 4 * I_UP) { const int j = r / I_UP; r -= j * I_UP; const int nb = r % 176, kb = r / 176; const int n0 = 32 * nb;
                const int cc = (n0 < FF) ? n0 : n0 - FF; const int drow = 256 * (cc / 128) + ((n0 < FF) ? 0 : 128) + (cc % 128);
                p0_transpose_item(ffn_w_up + (size_t)j * 1024 * FF2, 1024, FF2, WUP + (size_t)j * FF2 * 1024, 64 * kb, n0, drow, scr, lane); continue; } r -= 4 * I_UP;
            { const int j = r / I_DN; r -= j * I_DN; const int nb = r % 32, kb = r / 32;
                p0_transpose_item(ffn_w_down + (size_t)j * FF * 1024, FF, 1024, WDN + (size_t)j * 1024 * FF, 64 * kb, 32 * nb, 32 * nb, scr, lane); }
        }
        for (int i = bx * 512 + tid; i < T * 128; i += G * 512) { const int t = i >> 7, j = i & 127;
            const double inv = exp(-9.210340371976184 * (double)j / 127.0); const double ang = (double)t * inv;
            float2 o; o.x = (float)cos(ang); o.y = (float)sin(ang); *(float2*)(rope + 2 * (size_t)i) = o; }
        for (int i = bx * 512 + tid; i < 48 * att::BT_STRIDE; i += G * 512) { const int gh = i / att::BT_STRIDE, e = i % att::BT_STRIDE, delta = e - 32, g = gh >> 4;
            float v = 0.f; if (delta >= 0 && delta <= 128) v = rel_bias[gh * 32 + t5_bucket(delta << (2 * g))] * LOG2E;
            btab[i] = v; }
        for (int m = gw; m < M; m += NGW) { const GAS f32x4* xr = (const GAS f32x4*)(x_in + (size_t)m * D) + lane; GAS unsigned long long* o8 = (GAS unsigned long long*)(XB + (size_t)m * D) + lane;
#pragma unroll
            for (int j = 0; j < 4; ++j) { const f32x4 v = xr[64 * j]; o8[64 * j] = (unsigned long long)pk2(v.x, v.y) | ((unsigned long long)pk2(v.z, v.w) << 32); } }
    }
#endif
    GRID_BAR();

    for (int sub = 0; sub < 8; ++sub) {
        const int layer = sub >> 1, kind = sub & 3, inst = layer >> 1;
        const bf16* Aop; const bf16* Bop; int Kop;
        if (kind == 0) {
#if PH & 2
            { pg8::Gemm g{XB, WRI + (size_t)inst * RET_IN * 1024, M, 4096, 1024}; pg8::StaticOrder S; S.init(M, 4096, G, bx);
              pg8::EpiRetQKV E{QK, VB, rope};
              pg8::gemm_phase<pg8::EpiRetQKV, pg8::StaticOrder, true, true>(lds + RING_OFF, g, S, E, OPQ_TID()); }
#endif
            GRID_BAR();
#if PH & 4
            ret::ret_phase(vcu, G, QK, VB, STATS, lds + RING_OFF, OPQ_TID());
#endif
            GRID_BAR();
#if PH & 8
            { pg8::Gemm g{XB, WRI + (size_t)inst * RET_IN * 1024 + (size_t)4096 * 1024, M, 2048, 1024}; pg8::StaticOrder S; S.init(M, 2048, G, bx);
              pg8::EpiRetGate E{VB, STATS, GN_EPS};
              pg8::gemm_phase<pg8::EpiRetGate, pg8::StaticOrder, true, true>(lds + RING_OFF, g, S, E, OPQ_TID()); }
#endif
            GRID_BAR();
            Aop = VB; Bop = WRO + (size_t)inst * 1024 * RET_V; Kop = RET_V;
        } else if (kind == 2) {
            for (int g3 = 0; g3 < 3; ++g3) {
#if PH & 16
                { pg8::Gemm g{XB, WAI + (size_t)inst * ATT_IN * 1024 + (size_t)g3 * 3072 * 1024, M, 3072, 1024}; pg8::StaticOrder S; S.init(M, 3072, G, bx);
                  pg8::EpiBf16<0> E{QKV, 1024, nullptr, 1024, (size_t)M * 1024, 0.125f * LOG2E};
                  pg8::gemm_phase<pg8::EpiBf16<0>, pg8::StaticOrder, true, true>(lds + RING_OFF, g, S, E, OPQ_TID()); }
#endif
                GRID_BAR();
#if PH & 32
                att::att_phase(g3, vcu, G, QKV, OA, LSE, btab, lds + RING_OFF, OPQ_TID());
#endif
                GRID_BAR();
            }
            Aop = OA; Bop = WAO + (size_t)inst * 1024 * 1024; Kop = 1024;
        } else {
#if PH & 64
            { pg8::Gemm g{XB, WUP + (size_t)layer * FF2 * 1024, M, FF2, 1024}; pg8::StaticOrder S; S.init(M, FF2, G, bx);
              pg8::EpiSwiglu E{HB, FF};
              pg8::gemm_phase<pg8::EpiSwiglu, pg8::StaticOrder, true, true>(lds + RING_OFF, g, S, E, OPQ_TID()); }
#endif
            GRID_BAR();
            Aop = HB; Bop = WDN + (size_t)layer * 1024 * FF; Kop = FF;
        }
#if PH & 128
        { pg8::Gemm g{Aop, Bop, M, 1024, Kop}; pg8::StaticOrder S; S.init(M, 1024, G, bx);
          pg8::EpiResid E{sub == 0 ? x_in : (const float*)X, X, DN_ALPHA};
          pg8::gemm_phase<pg8::EpiResid, pg8::StaticOrder, true, true>(lds + RING_OFF, g, S, E, OPQ_TID()); }
#endif
        GRID_BAR();
#if PH & 256
        { const int lane = OPQ_TID() & 63;
          const float* gp = ln_gain + (size_t)(layer * 2 + (kind & 1)) * D; const float* bp = ln_bias + (size_t)(layer * 2 + (kind & 1)) * D;
          f32x4 gv[4], bv[4];
#pragma unroll
          for (int j = 0; j < 4; ++j) { gv[j] = *((const f32x4*)gp + lane + 64 * j); bv[j] = *((const f32x4*)bp + lane + 64 * j); }
          for (int m = gw; m < M; m += NGW) { GAS f32x4* xr = (GAS f32x4*)(X + (size_t)m * D) + lane; GAS unsigned long long* o8 = (GAS unsigned long long*)(XB + (size_t)m * D) + lane;
              f32x4 v[4]; float s = 0.f;
#pragma unroll
              for (int j = 0; j < 4; ++j) { v[j] = xr[64 * j]; s += (v[j].x + v[j].y) + (v[j].z + v[j].w); }
              const float mean = wave_sum(s) * (1.f / D); float s2 = 0.f;
#pragma unroll
              for (int j = 0; j < 4; ++j) { v[j] = v[j] - mean; s2 += (v[j].x * v[j].x + v[j].y * v[j].y) + (v[j].z * v[j].z + v[j].w * v[j].w); }
              const float rstd = 1.f / sqrtf(wave_sum(s2) * (1.f / D) + LN_EPS);
#pragma unroll
              for (int j = 0; j < 4; ++j) { const f32x4 o = v[j] * rstd * gv[j] + bv[j]; xr[64 * j] = o; o8[64 * j] = (unsigned long long)pk2(o.x, o.y) | ((unsigned long long)pk2(o.z, o.w) << 32); } }
        }
#endif
        if (sub != 7) GRID_BAR();
    }
#undef GRID_BAR
}

extern "C" void kernel_launch(void* const* d_in, const int* in_sizes, int n_in, void* d_out, int out_size, void* d_ws, size_t ws_size, hipStream_t stream) {
    static int grid = 0;
    if (grid == 0) {
        if (n_in != 10 || in_sizes[0] != M * D || out_size != M * D || ws_size < WS_END) { fprintf(stderr, "kernel_launch: shape/workspace mismatch (n_in %d, in0 %d, out %d, ws %zu, need %zu); nothing launched\n", n_in, n_in > 0 ? in_sizes[0] : -1, out_size, ws_size, (size_t)WS_END); grid = -1; return; }
        int dev = 0, cus = 0, per_cu = 0;
        if (hipGetDevice(&dev) != hipSuccess || hipDeviceGetAttribute(&cus, hipDeviceAttributeMultiprocessorCount, dev) != hipSuccess) { grid = -1; return; }
        if (hipFuncSetAttribute((const void*)mk_fwd, hipFuncAttributeMaxDynamicSharedMemorySize, LDS_BYTES) != hipSuccess) { fprintf(stderr, "kernel_launch: hipFuncSetAttribute failed\n"); grid = -1; return; }
        if (hipOccupancyMaxActiveBlocksPerMultiprocessor(&per_cu, (const void*)mk_fwd, NWAVES * 64, LDS_BYTES) != hipSuccess || per_cu < 1) { fprintf(stderr, "kernel_launch: occupancy query reports %d\n", per_cu); }
        (void)hipGetLastError();
        grid = cus;
    }
    if (grid < 0) return;
    if (hipMemsetAsync((char*)d_ws + WS_CTL, 0, CTL_ZERO_BYTES, stream) != hipSuccess) { fprintf(stderr, "kernel_launch: memset failed\n"); return; }
    Args a{};
    for (int i = 0; i < 10; ++i) a.in[i] = (const float*)d_in[i];
    a.out = (float*)d_out; a.ws = (unsigned char*)d_ws;
    hipLaunchKernelGGL(mk_fwd, dim3(grid), dim3(NWAVES * 64), LDS_BYTES, stream, a);
    const hipError_t le = hipPeekAtLastError();
    if (le != hipSuccess) fprintf(stderr, "kernel_launch: launch failed: %s\n", hipGetErrorName(le));
}
```
